# Optimizing an MI355X kernel written in HIP

```python
import jax, jax.numpy as jnp
from jax import lax
import numpy as np

D_MODEL = 1024
BATCH = 4
SEQ = 8192
DEPTH = 1

N_META = 16
HEAD_DIM = 64
ATTN_HEADS = (D_MODEL // 2) // HEAD_DIM
KV_HEADS = 2
GQA_GROUP = ATTN_HEADS // KV_HEADS
ATTN_WIDTH = ATTN_HEADS * HEAD_DIM
KV_WIDTH = KV_HEADS * HEAD_DIM
LRU_WIDTH = D_MODEL // 2
LRU_BLOCKS = 8
LRU_BLOCK = LRU_WIDTH // LRU_BLOCKS
LRU_C = 8.0
CONV_WIDTH = 4
WINDOW = 128
BLOCK = 128
PAD = BLOCK - N_META
MIX_WIDTH = ATTN_WIDTH + LRU_WIDTH
IN_WIDTH = ATTN_WIDTH + 2 * KV_WIDTH + 2 * LRU_WIDTH
D_FF = 4 * D_MODEL
EPS = 1e-6
NEG = -1e30

kernel_name = "hymba_griffin_swa_sink_hybrid"


def rmsnorm(x, g):
    xf = x.astype(jnp.float32)
    y = xf * lax.rsqrt(jnp.mean(xf * xf, axis=-1, keepdims=True) + EPS)
    return (y * g.astype(jnp.float32)).astype(x.dtype)


def causal_depthwise_conv(x, w, b):
    c = x.shape[-1]
    y = lax.conv_general_dilated(
        x, w[:, None, :].astype(x.dtype), window_strides=(1,),
        padding=[(CONV_WIDTH - 1, 0)],
        dimension_numbers=("NWC", "WIO", "NWC"), feature_group_count=c)
    return y + b.astype(x.dtype)


def rg_lru(x, w_a, b_a, w_x, b_x, lam):
    bsz, t, _ = x.shape
    xb = x.reshape(bsz, t, LRU_BLOCKS, LRU_BLOCK)
    gate_r = jnp.einsum("btnc,ncd->btnd", xb, w_a).reshape(bsz, t, LRU_WIDTH) + b_a
    gate_i = jnp.einsum("btnc,ncd->btnd", xb, w_x).reshape(bsz, t, LRU_WIDTH) + b_x
    r = jax.nn.sigmoid(gate_r.astype(jnp.float32))
    i = jax.nn.sigmoid(gate_i.astype(jnp.float32))
    log_a = -LRU_C * r * jax.nn.softplus(-lam.astype(jnp.float32))
    a = jnp.exp(log_a)
    mult = jnp.sqrt(-jnp.expm1(2.0 * log_a))
    u = mult * (i * x.astype(jnp.float32))

    def combine(left, right):
        a_l, b_l = left
        a_r, b_r = right
        return a_l * a_r, a_r * b_l + b_r

    _, h = lax.associative_scan(combine, (a, u), axis=1)
    return h


def sliding_window_attention_with_sinks(q, k, v, sinks):
    bsz, t, _, _ = q.shape
    pad_cfg = ((0, 0), (PAD, 0), (0, 0), (0, 0))
    qp, kp, vp = jnp.pad(q, pad_cfg), jnp.pad(k, pad_cfg), jnp.pad(v, pad_cfg)
    tp = t + PAD
    nb = tp // BLOCK
    qb = qp.reshape(bsz, nb, BLOCK, KV_HEADS, GQA_GROUP, HEAD_DIM)
    kb = kp.reshape(bsz, nb, BLOCK, KV_HEADS, HEAD_DIM)
    vb = vp.reshape(bsz, nb, BLOCK, KV_HEADS, HEAD_DIM)
    blk_pad = ((0, 0), (1, 0), (0, 0), (0, 0), (0, 0))
    kk = jnp.concatenate([jnp.pad(kb, blk_pad)[:, :-1], kb], axis=2)
    vv = jnp.concatenate([jnp.pad(vb, blk_pad)[:, :-1], vb], axis=2)
    scale = HEAD_DIM ** -0.5
    s = jnp.einsum("bnqkgd,bnskd->bnkgqs", qb, kk,
                   preferred_element_type=jnp.float32) * scale
    blk = jnp.arange(nb)[:, None] * BLOCK
    qpos = blk + jnp.arange(BLOCK)[None, :]
    kpos = blk - BLOCK + jnp.arange(2 * BLOCK)[None, :]
    diff = qpos[:, :, None] - kpos[:, None, :]
    valid = (diff >= 0) & (diff < WINDOW) & (kpos[:, None, :] >= PAD)
    s = jnp.where(valid[None, :, None, None], s, NEG)
    sink = sinks.astype(jnp.float32).reshape(1, 1, KV_HEADS, GQA_GROUP, 1, 1)
    m = jnp.maximum(jnp.max(s, axis=-1, keepdims=True), sink)
    p = jnp.exp(s - m)
    denom = jnp.sum(p, axis=-1, keepdims=True) + jnp.exp(sink - m)
    o = jnp.einsum("bnkgqs,bnskd->bnqkgd", (p / denom).astype(v.dtype), vv)
    return o.reshape(bsz, tp, ATTN_WIDTH)[:, PAD:]


def setup_inputs(seed: int = 0) -> dict:
    key = jax.random.key(seed)
    ks = jax.random.split(key, 20)
    f32 = jnp.float32

    def nrm(k, shape, scale):
        return jax.random.normal(k, shape, f32) * scale

    u = jax.random.uniform(ks[10], (DEPTH, LRU_WIDTH), f32, 0.9, 0.999)
    a0 = u ** (1.0 / LRU_C)
    lru_lambda = jnp.log(a0) - jnp.log1p(-a0)
    return {
        "x": nrm(ks[0], (BATCH, SEQ, D_MODEL), 1.0),
        "meta_tokens": nrm(ks[1], (N_META, D_MODEL), 1.0),
        "g_pre_mix": 1.0 + nrm(ks[2], (DEPTH, D_MODEL), 0.05),
        "w_in": nrm(ks[3], (DEPTH, D_MODEL, IN_WIDTH), D_MODEL ** -0.5),
        "conv_w": nrm(ks[4], (DEPTH, CONV_WIDTH, LRU_WIDTH), CONV_WIDTH ** -0.5),
        "conv_b": nrm(ks[5], (DEPTH, LRU_WIDTH), 0.01),
        "w_a": nrm(ks[6], (DEPTH, LRU_BLOCKS, LRU_BLOCK, LRU_BLOCK), LRU_BLOCK ** -0.5),
        "b_a": nrm(ks[7], (DEPTH, LRU_WIDTH), 0.01),
        "w_x": nrm(ks[8], (DEPTH, LRU_BLOCKS, LRU_BLOCK, LRU_BLOCK), LRU_BLOCK ** -0.5),
        "b_x": nrm(ks[9], (DEPTH, LRU_WIDTH), 0.01),
        "lru_lambda": lru_lambda,
        "attn_sinks": nrm(ks[11], (DEPTH, ATTN_HEADS), 0.5),
        "w_out": nrm(ks[12], (DEPTH, MIX_WIDTH, D_MODEL), MIX_WIDTH ** -0.5),
        "g_post_mix": 1.0 + nrm(ks[13], (DEPTH, D_MODEL), 0.05),
        "g_pre_ffn": 1.0 + nrm(ks[14], (DEPTH, D_MODEL), 0.05),
        "w_ff1": nrm(ks[15], (DEPTH, D_MODEL, D_FF), D_MODEL ** -0.5),
        "w_ff2": nrm(ks[16], (DEPTH, D_FF, D_MODEL), D_FF ** -0.5),
        "g_post_ffn": 1.0 + nrm(ks[17], (DEPTH, D_MODEL), 0.05),
    }


def reference(x, meta_tokens, g_pre_mix, w_in, conv_w, conv_b, w_a, b_a, w_x, b_x,
              lru_lambda, attn_sinks, w_out, g_post_mix, g_pre_ffn, w_ff1, w_ff2,
              g_post_ffn):
    bsz = x.shape[0]
    meta = jnp.broadcast_to(meta_tokens[None].astype(x.dtype), (bsz, N_META, D_MODEL))
    h = jnp.concatenate([meta, x], axis=1)
    t = h.shape[1]
    split_at = [ATTN_WIDTH, ATTN_WIDTH + KV_WIDTH, ATTN_WIDTH + 2 * KV_WIDTH,
                ATTN_WIDTH + 2 * KV_WIDTH + LRU_WIDTH]
    for l in range(DEPTH):
        u = rmsnorm(h, g_pre_mix[l])
        z = u @ w_in[l]
        q, k, v, xr, yr = jnp.split(z, split_at, axis=-1)
        attn = sliding_window_attention_with_sinks(
            q.reshape(bsz, t, ATTN_HEADS, HEAD_DIM),
            k.reshape(bsz, t, KV_HEADS, HEAD_DIM),
            v.reshape(bsz, t, KV_HEADS, HEAD_DIM),
            attn_sinks[l])
        xr = causal_depthwise_conv(xr, conv_w[l], conv_b[l])
        hr = rg_lru(xr, w_a[l], b_a[l], w_x[l], b_x[l], lru_lambda[l])
        rec = (jax.nn.gelu(yr.astype(jnp.float32)) * hr).astype(h.dtype)
        mix = jnp.concatenate([attn.astype(h.dtype), rec], axis=-1) @ w_out[l]
        h = h + rmsnorm(mix, g_post_mix[l])
        u = rmsnorm(h, g_pre_ffn[l])
        f = jnp.square(jax.nn.relu(u @ w_ff1[l])) @ w_ff2[l]
        h = h + rmsnorm(f, g_post_ffn[l])
    return h[:, N_META:]
```

```cpp
#include <hip/hip_runtime.h>
#include <hip/hip_cooperative_groups.h>
#include <cstdio>
#include <cstdint>
namespace cg = cooperative_groups;
namespace pg8 {
#define PG8_LAS __attribute__((address_space(3)))
typedef unsigned short bf16_t;
typedef short bf16x8 __attribute__((ext_vector_type(8)));
typedef float f32x4 __attribute__((ext_vector_type(4)));
typedef unsigned u32x4 __attribute__((ext_vector_type(4)));
constexpr int BM = 256, BK = 64, HALF = 128, HTB = HALF * BK * 2  , STAGE_BYTES = 8 * HTB, NXCD = 8, WGM = 8;

__host__ __device__ __forceinline__ int lds_byte(int r, int c) { const int st = (r >> 4) * 2 + (c >> 5), rr = r & 15, cc = c & 31, ob = rr * 64 + cc * 2; return st * 1024 + (ob ^ (((ob >> 9) & 1) << 5)); }
__host__ __device__ __forceinline__ void stage_rc(int b, int& R, int& C) { const int st = b / 1024, sb = b % 1024, swz = sb ^ (((sb >> 9) & 1) << 5); R = (st >> 1) * 16 + swz / 64; C = (st & 1) * 32 + (swz % 64) / 2; }
__host__ __device__ __forceinline__ int perm32(int rho) { const int n = rho >> 4, i = rho & 15; return 8 * (i >> 2) + 4 * n + (i & 3); }

struct Unit { int pm, pn; };
struct Gemm { const bf16_t* A; const bf16_t* Bt; int M, N, K; };

struct StaticOrder {
    int nM, nN, nwg, G, c;
    __host__ __device__ void init(int M, int N, int G_, int c_) { nM = M / BM; nN = N / BM; nwg = nM * nN; G = G_; c = c_; }
    __host__ __device__ bool next(int i, Unit& u) const {
        const long L = (long)i * G + c; if (L >= nwg) return false;
        int wgid = (int)L; { const int q = nwg / NXCD, r = nwg % NXCD, xcd = wgid % NXCD, off = wgid / NXCD; wgid = (xcd < r ? xcd * (q + 1) : r * (q + 1) + (xcd - r) * q) + off; }
        const int nig = WGM * nN, gid = wgid / nig, fm = gid * WGM, gsz = (nM - fm) < WGM ? (nM - fm) : WGM;
        u.pm = fm + ((wgid % nig) % gsz); u.pn = (wgid % nig) / gsz; return true;
    }
    __device__ __forceinline__ void a_ready(const Unit&) const {}
    __device__ __forceinline__ void done(const Unit&) const {}
};

__device__ __forceinline__ unsigned cvt_pk_bf16(float lo, float hi) { unsigned r; asm volatile("v_cvt_pk_bf16_f32 %0, %1, %2" : "=v"(r) : "v"(lo), "v"(hi)); return r; }
typedef float f32x2 __attribute__((ext_vector_type(2)));
__device__ __forceinline__ f32x2 gelu_pk(f32x2 v) {
    const f32x2 av = __builtin_elementwise_abs(v), d = av * 0.2316418882f + 1.0f;
    f32x2 t; t.x = __builtin_amdgcn_rcpf(d.x); t.y = __builtin_amdgcn_rcpf(d.y);
    f32x2 q = t * 0.5307027145f + (-0.7265760135f); q = q * t + 0.7107068705f; q = q * t + (-0.142248368f); q = q * t + 0.127414796f; q = q * t;
    const f32x2 s = (v * v) * (-0.72134752044f);
    f32x2 e; e.x = __builtin_amdgcn_exp2f(s.x); e.y = __builtin_amdgcn_exp2f(s.y);
    const f32x2 m = v * (q * e), r = v - m;
    f32x2 o; o.x = v.x < 0.f ? m.x : r.x; o.y = v.y < 0.f ? m.y : r.y; return o;
}

template <int ACT  > struct EpiBf16 {
    static constexpr bool PERM = true, AFTER_DRAIN = false; static_assert(ACT == 0 || ACT == 1 || ACT == 2, "EpiBf16: ACT is 0 (none), 1 (gelu_pk) or 2 (relu^2)");
    bf16_t* O; int ldc; const float* bias; int split_cols; size_t split_stride; float scale0;
    __device__ __forceinline__ void operator()(const f32x4 (&acc)[2][2][4][2], const Unit& u, int wr, int wc, int fr, int fq) const {
        const int row0 = u.pm * BM + wr * 64 + fr; int colt = u.pn * BM; bf16_t* base = O;
        float sc = 1.f; if (split_cols) { const int t = colt / split_cols; base += (size_t)t * split_stride; colt -= t * split_cols; if (t == 0) sc = scale0; }
        const int col0 = colt + wc * 32 + 8 * fq, bcol0 = u.pn * BM + wc * 32 + 8 * fq;
        f32x4 bv[2][2];
#pragma unroll
        for (int bj = 0; bj < 2; ++bj)
#pragma unroll
            for (int n = 0; n < 2; ++n) bv[bj][n] = bias ? *(const f32x4*)(bias + bcol0 + bj * HALF + 4 * n) : (f32x4){0.f, 0.f, 0.f, 0.f};
#pragma unroll
        for (int ai = 0; ai < 2; ++ai)
#pragma unroll
            for (int m = 0; m < 4; ++m) { bf16_t* rowp = base + (size_t)(row0 + ai * HALF + m * 16) * ldc + col0;
#pragma unroll
                for (int bj = 0; bj < 2; ++bj) { f32x4 v0 = acc[ai][bj][m][0] + bv[bj][0], v1 = acc[ai][bj][m][1] + bv[bj][1];
                    if (ACT == 1) { f32x2 a = gelu_pk((f32x2){v0[0], v0[1]}), b = gelu_pk((f32x2){v0[2], v0[3]}), c = gelu_pk((f32x2){v1[0], v1[1]}), d = gelu_pk((f32x2){v1[2], v1[3]});
                        v0 = (f32x4){a.x, a.y, b.x, b.y}; v1 = (f32x4){c.x, c.y, d.x, d.y}; }
                    if (ACT == 2) { const f32x4 z4 = (f32x4){0.f, 0.f, 0.f, 0.f}; v0 = __builtin_elementwise_max(v0, z4); v1 = __builtin_elementwise_max(v1, z4); v0 = v0 * v0; v1 = v1 * v1; }
                    v0 = v0 * sc; v1 = v1 * sc; u32x4 w; w.x = cvt_pk_bf16(v0[0], v0[1]); w.y = cvt_pk_bf16(v0[2], v0[3]); w.z = cvt_pk_bf16(v1[0], v1[1]); w.w = cvt_pk_bf16(v1[2], v1[3]);
                    *(u32x4*)(rowp + bj * HALF) = w; } }
    }
};
template <class Epi, class Sched, bool ALIGN_EPI = false, bool SP2 = false>
__device__ __forceinline__ void gemm_phase(PG8_LAS unsigned char* lds, const Gemm g, const Sched& S, const Epi& E) {
    const int tid = threadIdx.x, wid = __builtin_amdgcn_readfirstlane(tid >> 6), lane = tid & 63, wr = wid >> 2, wc = wid & 3, fr = lane & 15, fq = lane >> 4;
    const int K = g.K, nt = K / BK;
    unsigned voffA[2], voffB[2];
#pragma unroll
    for (int i = 0; i < 2; ++i) { int R, C; stage_rc(tid * 16 + i * 8192, R, C); const int Rb = Epi::PERM ? ((R & ~31) + perm32(R & 31)) : R;
        voffA[i] = (unsigned)(R * K + C) * 2u; voffB[i] = (unsigned)(Rb * K + C) * 2u; }
    const size_t kstep = (size_t)(BK * 2);
    const size_t hstep = (size_t)HALF * K * 2;
    const size_t tstep = 2 * hstep;
    const unsigned ldsw = (unsigned)wid * 1024u;
    const int aoff = lds_byte(wr * 64 + fr, fq * 8), boff = lds_byte(wc * 32 + fr, fq * 8);
#define PG8_SA(b, h) (((b) * 2 + (h)) * HTB)
#define PG8_SB(b, h) ((4 + (b) * 2 + (h)) * HTB)
#define PG8_STAGE(bufoff, gbase, voff) do { _Pragma("unroll") for (int _i = 0; _i < 2; ++_i) \
        __builtin_amdgcn_global_load_lds((const unsigned*)((const char*)(gbase) + (voff)[_i]), (PG8_LAS unsigned*)(lds + (bufoff) + ldsw + _i * 8192), 16, 0, 0); } while (0)
#define PG8_LDA(dst, b, h) do { _Pragma("unroll") for (int m = 0; m < 4; ++m) _Pragma("unroll") for (int k = 0; k < 2; ++k) dst[m][k] = *(const PG8_LAS bf16x8*)(lds + PG8_SA(b, h) + aoff + m * 2048 + k * 1024); } while (0)
#define PG8_LDB(dst, b, h) do { _Pragma("unroll") for (int n = 0; n < 2; ++n) _Pragma("unroll") for (int k = 0; k < 2; ++k) dst[n][k] = *(const PG8_LAS bf16x8*)(lds + PG8_SB(b, h) + boff + n * 2048 + k * 1024); } while (0)
#define PG8_MMA(ai, bj, At, Bt) do { __builtin_amdgcn_s_setprio(1); _Pragma("unroll") for (int m = 0; m < 4; ++m) _Pragma("unroll") for (int n = 0; n < 2; ++n) _Pragma("unroll") for (int k = 0; k < 2; ++k) \
        acc[ai][bj][m][n] = __builtin_amdgcn_mfma_f32_16x16x32_bf16(Bt[n][k], At[m][k], acc[ai][bj][m][n], 0, 0, 0); __builtin_amdgcn_s_setprio(0); } while (0)
#define PG8_WAIT_V(n) asm volatile("s_waitcnt vmcnt(" #n ")" ::: "memory")
#define PG8_WAIT_L(n) asm volatile("s_waitcnt lgkmcnt(" #n ")" ::: "memory")
#define PG8_BAR __builtin_amdgcn_s_barrier()
#define PG8_SCHED __builtin_amdgcn_sched_barrier(0)
    Unit cur, nxt; int ui = 0;
    if (!S.next(0, cur)) return;
    f32x4 acc[2][2][4][2];
#pragma unroll
    for (int a = 0; a < 2; ++a)
#pragma unroll
        for (int b = 0; b < 2; ++b)
#pragma unroll
            for (int m = 0; m < 4; ++m)
#pragma unroll
                for (int n = 0; n < 2; ++n) acc[a][b][m][n] = (f32x4){0.f, 0.f, 0.f, 0.f};
    bf16x8 At[4][2], B0[2][2], B1[2][2];
    const char* cA = (const char*)g.A + (size_t)cur.pm * tstep; const char* cB = (const char*)g.Bt + (size_t)cur.pn * tstep;
    S.a_ready(cur);
    if constexpr (SP2) {
        PG8_STAGE(PG8_SB(0, 0), cB, voffB); PG8_STAGE(PG8_SB(0, 1), cB + hstep, voffB); PG8_STAGE(PG8_SA(0, 0), cA, voffA); PG8_STAGE(PG8_SA(0, 1), cA + hstep, voffA);
        if (wr == 1) PG8_BAR;
        PG8_WAIT_V(2); PG8_BAR;
        PG8_STAGE(PG8_SB(1, 0), cB + kstep, voffB); PG8_STAGE(PG8_SA(1, 0), cA + kstep, voffA); PG8_STAGE(PG8_SB(1, 1), cB + hstep + kstep, voffB);
        PG8_WAIT_V(6); PG8_BAR;
    } else {
        PG8_STAGE(PG8_SB(0, 0), cB, voffB); PG8_STAGE(PG8_SA(0, 0), cA, voffA); PG8_STAGE(PG8_SB(0, 1), cB + hstep, voffB); PG8_STAGE(PG8_SA(0, 1), cA + hstep, voffA);
        if (wr == 1) PG8_BAR;
        PG8_WAIT_V(4); PG8_BAR;
        PG8_STAGE(PG8_SB(1, 0), cB + kstep, voffB); PG8_STAGE(PG8_SA(1, 0), cA + kstep, voffA); PG8_STAGE(PG8_SB(1, 1), cB + hstep + kstep, voffB);
        PG8_WAIT_V(6); PG8_BAR;
    }
    for (;;) {
        const bool has_next = S.next(ui + 1, nxt);
        const char* nA = has_next ? (const char*)g.A + (size_t)nxt.pm * tstep : cA; const char* nB = has_next ? (const char*)g.Bt + (size_t)nxt.pn * tstep : cB;
        for (int t = 0; t < nt; t += 2) {
            const bool last = (t == nt - 2);
            const char* a1 = cA + (size_t)(t + 1) * kstep;
            const char* a2 = last ? nA : cA + (size_t)(t + 2) * kstep; const char* b2 = last ? nB : cB + (size_t)(t + 2) * kstep;
            const char* a3 = a2 + kstep; const char* b3 = b2 + kstep;
            if (last && has_next) S.a_ready(nxt);
            if constexpr (SP2) {
            PG8_LDB(B0, 0, 0); PG8_LDB(B1, 0, 1); PG8_SCHED; PG8_LDA(At, 0, 0); PG8_STAGE(PG8_SA(1, 1), a1 + hstep, voffA);
            PG8_WAIT_V(8); PG8_WAIT_L(0); PG8_BAR; PG8_MMA(0, 0, At, B0); PG8_MMA(0, 1, At, B1); PG8_BAR; PG8_SCHED;
            PG8_LDA(At, 0, 1); PG8_STAGE(PG8_SB(0, 0), b2, voffB); PG8_STAGE(PG8_SB(0, 1), b2 + hstep, voffB); PG8_STAGE(PG8_SA(0, 0), a2, voffA);
            PG8_WAIT_V(8); PG8_WAIT_L(0); PG8_BAR; PG8_MMA(1, 0, At, B0); PG8_MMA(1, 1, At, B1); PG8_BAR; PG8_SCHED;
            PG8_LDB(B0, 1, 0); PG8_LDB(B1, 1, 1); PG8_SCHED; PG8_LDA(At, 1, 0); PG8_STAGE(PG8_SA(0, 1), a2 + hstep, voffA);
            PG8_WAIT_V(8); PG8_WAIT_L(0); PG8_BAR; PG8_MMA(0, 0, At, B0); PG8_MMA(0, 1, At, B1); PG8_BAR; PG8_SCHED;
            PG8_LDA(At, 1, 1); PG8_STAGE(PG8_SB(1, 0), b3, voffB); PG8_STAGE(PG8_SB(1, 1), b3 + hstep, voffB); PG8_STAGE(PG8_SA(1, 0), a3, voffA);
            PG8_WAIT_V(8); PG8_WAIT_L(0); PG8_BAR; PG8_MMA(1, 0, At, B0); PG8_MMA(1, 1, At, B1); PG8_BAR; PG8_SCHED;
            } else {
            PG8_LDB(B0, 0, 0); PG8_SCHED; PG8_LDA(At, 0, 0); PG8_STAGE(PG8_SA(1, 1), a1 + hstep, voffA);
            PG8_WAIT_L(8); PG8_BAR; PG8_WAIT_L(0); PG8_MMA(0, 0, At, B0); PG8_BAR; PG8_SCHED;
            PG8_LDB(B1, 0, 1); PG8_STAGE(PG8_SB(0, 0), b2, voffB);
            PG8_BAR; PG8_WAIT_L(0); PG8_MMA(0, 1, At, B1); PG8_BAR;
            PG8_LDA(At, 0, 1); PG8_STAGE(PG8_SA(0, 0), a2, voffA);
            PG8_BAR; PG8_WAIT_L(0); PG8_MMA(1, 0, At, B0); PG8_BAR; PG8_SCHED;
            PG8_STAGE(PG8_SB(0, 1), b2 + hstep, voffB);
            PG8_WAIT_V(6); PG8_BAR; PG8_MMA(1, 1, At, B1); PG8_BAR;
            PG8_LDB(B0, 1, 0); PG8_SCHED; PG8_LDA(At, 1, 0); PG8_STAGE(PG8_SA(0, 1), a2 + hstep, voffA);
            PG8_WAIT_L(8); PG8_BAR; PG8_WAIT_L(0); PG8_MMA(0, 0, At, B0); PG8_BAR; PG8_SCHED;
            PG8_LDB(B1, 1, 1); PG8_STAGE(PG8_SB(1, 0), b3, voffB);
            PG8_BAR; PG8_WAIT_L(0); PG8_MMA(0, 1, At, B1); PG8_BAR;
            PG8_LDA(At, 1, 1); PG8_STAGE(PG8_SA(1, 0), a3, voffA);
            PG8_BAR; PG8_WAIT_L(0); PG8_MMA(1, 0, At, B0); PG8_BAR; PG8_SCHED;
            PG8_STAGE(PG8_SB(1, 1), b3 + hstep, voffB);
            PG8_WAIT_V(6); PG8_BAR; PG8_MMA(1, 1, At, B1); PG8_BAR;
            }
        }
        if constexpr (ALIGN_EPI) { if (wr == 0) PG8_BAR; }
        if constexpr (!Epi::AFTER_DRAIN) { E(acc, cur, wr, wc, fr, fq); S.done(cur); }
        if (!has_next) break;
#pragma unroll
        for (int a = 0; a < 2; ++a)
#pragma unroll
            for (int b = 0; b < 2; ++b)
#pragma unroll
                for (int m = 0; m < 4; ++m)
#pragma unroll
                    for (int n = 0; n < 2; ++n) acc[a][b][m][n] = (f32x4){0.f, 0.f, 0.f, 0.f};
        cur = nxt; cA = nA; cB = nB; ++ui;
        if constexpr (ALIGN_EPI) { if (wr == 1) PG8_BAR; }
    }
    PG8_WAIT_V(0);
    if constexpr (!ALIGN_EPI) { if (wr == 0) PG8_BAR; }
    PG8_BAR;
    if constexpr (Epi::AFTER_DRAIN) { E.fused(acc, cur, wr, wc, fr, fq, lds, wid, lane); S.done(cur); }
#undef PG8_SA
#undef PG8_SB
#undef PG8_STAGE
#undef PG8_LDA
#undef PG8_LDB
#undef PG8_MMA
#undef PG8_WAIT_V
#undef PG8_WAIT_L
#undef PG8_BAR
#undef PG8_SCHED
}
}

constexpr int NB = 4, SEQ = 8192, D = 1024, NMETA = 16, FF = 4096, INW = 1792, LRUW = 512;
constexpr int MTOK = NB * SEQ;
constexpr int MPAD = MTOK + 256;
constexpr int ZK = 512, ZV = 640, ZXR = 768, ZYR = 1280;
constexpr int NCHUNK = SEQ / 64;
constexpr float EPS = 1e-6f, LOG2E = 1.4426950408889634f;
constexpr float QSCALE = 0.125f * LOG2E;

constexpr size_t MiB = 1u << 20;
constexpr size_t WS_WIN = 1 * MiB, WS_WOUT = 5 * MiB, WS_W1 = 7 * MiB, WS_W2 = 15 * MiB;
constexpr size_t WS_XN = 24 * MiB;
constexpr size_t WS_Z = 89 * MiB;
constexpr size_t WS_MIX = 202 * MiB;
constexpr size_t WS_Y = 266 * MiB;
constexpr size_t WS_STASH = 330 * MiB;
constexpr size_t WS_SUMP = 394 * MiB, WS_SUMH = 395 * MiB, WS_METAH = 396 * MiB;
constexpr size_t WS_F = 400 * MiB;
constexpr size_t WS_HB = 89 * MiB;
constexpr size_t WS_END = 464 * MiB;

constexpr int LDS_BYTES = 147456;
constexpr int NWAVES = 8;

#define GAS __attribute__((address_space(1)))
#define LAS __attribute__((address_space(3)))
typedef unsigned short bf16;
typedef unsigned v4u __attribute__((ext_vector_type(4)));
typedef unsigned v2u __attribute__((ext_vector_type(2)));
typedef float f32x4 __attribute__((ext_vector_type(4)));
typedef float f32x16 __attribute__((ext_vector_type(16)));
typedef short bf16x8 __attribute__((ext_vector_type(8)));
typedef short s16x4 __attribute__((ext_vector_type(4)));
#define LDS_WAIT() asm volatile("s_waitcnt lgkmcnt(0)" ::: "memory")

__device__ __forceinline__ unsigned f2bf(float f) { unsigned u = __builtin_bit_cast(unsigned, f); return (u + 0x7fffu + ((u >> 16) & 1u)) >> 16; }
__device__ __forceinline__ unsigned pk2(float lo, float hi) { return f2bf(lo) | (f2bf(hi) << 16); }
__device__ __forceinline__ float bf2f(unsigned b) { return __builtin_bit_cast(float, b << 16); }
__device__ __forceinline__ int crow(int r, int hi) { return (r & 3) + 8 * (r >> 2) + 4 * hi; }
__device__ __forceinline__ float wave_sum(float v) {
#pragma unroll
    for (int o = 1; o < 64; o <<= 1) v += __shfl_xor(v, o);
    return v;
}
__device__ __forceinline__ float fexp2(float x) { return __builtin_amdgcn_exp2f(x); }
__device__ __forceinline__ float frcp(float x) { return __builtin_amdgcn_rcpf(x); }

struct Args { const float* in[18]; float* out; unsigned char* ws; };

__device__ __forceinline__ void p0_transpose_item(const float* W, int K, int N, bf16* WT, LAS float* scr, int item, int lane) {
    const int nblk = N / 32, kb = item / nblk, nb = item % nblk, k0 = 64 * kb, n0 = 32 * nb;
#pragma unroll 8
    for (int i = 0; i < 32; ++i) { const int kk = 2 * i + (lane >> 5); scr[kk * 33 + (lane & 31)] = W[(size_t)(k0 + kk) * N + n0 + (lane & 31)]; }
    LDS_WAIT(); asm volatile("" ::: "memory");
    const int c = lane & 7;
#pragma unroll
    for (int j = 0; j < 4; ++j) { const int n = (lane >> 3) + 8 * j; const LAS float* s = scr + (8 * c) * 33 + n;
        v4u o; o.x = pk2(s[0 * 33], s[1 * 33]); o.y = pk2(s[2 * 33], s[3 * 33]); o.z = pk2(s[4 * 33], s[5 * 33]); o.w = pk2(s[6 * 33], s[7 * 33]);
        *(GAS v4u*)(WT + (size_t)(n0 + n) * K + k0 + 8 * c) = o; }
    LDS_WAIT(); asm volatile("" ::: "memory");
}
__device__ __forceinline__ void rms_row_to_bf16(const float* xrow, const f32x4 (&g)[4], bf16* orow, int lane) {
    const GAS f32x4* xr = (const GAS f32x4*)xrow + lane;
    f32x4 v[4]; float s = 0.f;
#pragma unroll
    for (int j = 0; j < 4; ++j) { v[j] = xr[64 * j]; s += (v[j].x * v[j].x + v[j].y * v[j].y) + (v[j].z * v[j].z + v[j].w * v[j].w); }
    const float rs = 1.f / sqrtf(wave_sum(s) * (1.f / D) + EPS);
    GAS unsigned long long* o8 = (GAS unsigned long long*)orow + lane;
#pragma unroll
    for (int j = 0; j < 4; ++j) { const f32x4 w = v[j] * rs * g[j]; o8[64 * j] = (unsigned long long)pk2(w.x, w.y) | ((unsigned long long)pk2(w.z, w.w) << 32); }
}
__device__ __forceinline__ void p0_prologue(const Args& A, LAS unsigned char* lds, int wave, int lane, int G) {
    unsigned char* ws = A.ws;
    LAS float* scr = (LAS float*)(lds + wave * 16384);
    const int gw = blockIdx.x * NWAVES + wave, NGW = G * NWAVES;
    constexpr int I_IN = (D / 64) * (INW / 32), I_O = (D / 64) * (D / 32), I_1 = (D / 64) * (FF / 32), I_2 = (FF / 64) * (D / 32);
    constexpr int NITEMS = I_IN + I_O + I_1 + I_2;
    for (int it = gw; it < NITEMS; it += NGW) {
        int r = it;
        if (r < I_IN) { p0_transpose_item(A.in[3], D, INW, (bf16*)(ws + WS_WIN), scr, r, lane); continue; } r -= I_IN;
        if (r < I_O) { p0_transpose_item(A.in[12], D, D, (bf16*)(ws + WS_WOUT), scr, r, lane); continue; } r -= I_O;
        if (r < I_1) { p0_transpose_item(A.in[15], D, FF, (bf16*)(ws + WS_W1), scr, r, lane); continue; } r -= I_1;
        p0_transpose_item(A.in[16], FF, D, (bf16*)(ws + WS_W2), scr, r, lane);
    }
    f32x4 g[4];
#pragma unroll
    for (int j = 0; j < 4; ++j) g[j] = *((const GAS f32x4*)A.in[2] + lane + 64 * j);
    bf16* XN = (bf16*)(ws + WS_XN);
    for (int m = gw; m < MPAD; m += NGW) {
        if (m < MTOK) rms_row_to_bf16(A.in[0] + (size_t)m * D, g, XN + (size_t)m * D, lane);
        else if (m < MTOK + NMETA) rms_row_to_bf16(A.in[1] + (size_t)(m - MTOK) * D, g, XN + (size_t)m * D, lane);
        else { GAS unsigned long long* o8 = (GAS unsigned long long*)(XN + (size_t)m * D) + lane;
#pragma unroll
            for (int j = 0; j < 4; ++j) o8[64 * j] = 0ull; }
    }
}

constexpr int AT_KS = 0, AT_VS = 27648, AT_WS = 55296, AT_ST = 57344, AT_PITCH = 144;
__device__ __forceinline__ void attn_unit(int b, int kvh, int qt, const bf16* Z, const float* sinks, bf16* MIX, LAS unsigned char* lds, int tid) {
    const int lane = tid & 63, wid = __builtin_amdgcn_readfirstlane(tid >> 6), r32 = lane & 31, hi = lane >> 5;
    const int q0 = qt * 64, g = wid >> 1, qs = (wid & 1) * 32, h = kvh * 4 + g;
    LAS unsigned char* Ks = lds + AT_KS; LAS unsigned char* Vs = lds + AT_VS;
    LAS float* wsf = (LAS float*)(lds + AT_WS) + wid * 64;
    LAS bf16* stg = (LAS bf16*)(lds + AT_ST) + wid * 2048;
    const int jbase = q0 - 112;
#pragma unroll
    for (int i = 0; i < 3; ++i) {
        const int idx = tid + 512 * i, row = idx >> 3, ch = idx & 7, j = jbase + row;
        v4u kv = (v4u){0u, 0u, 0u, 0u}, vv = (v4u){0u, 0u, 0u, 0u};
        if (j >= 0) { const size_t grow = (j < NMETA) ? (size_t)(MTOK + j) : (size_t)(b * SEQ + j - NMETA);
            const bf16* p = Z + grow * INW + ZK + kvh * 64 + ch * 8; kv = *(const GAS v4u*)p; vv = *(const GAS v4u*)(p + 128); }
        *(LAS v4u*)(Ks + row * AT_PITCH + ch * 16) = kv; *(LAS v4u*)(Vs + row * AT_PITCH + ch * 16) = vv;
    }
    const bf16* Qp = Z + (size_t)(b * SEQ + q0 + qs + r32) * INW + h * 64 + hi * 8;
    bf16x8 qr[4];
#pragma unroll
    for (int d0 = 0; d0 < 4; ++d0) qr[d0] = *(const GAS bf16x8*)(Qp + d0 * 16);
    __syncthreads();
    f32x16 p[5];
#pragma unroll
    for (int t = 0; t < 5; ++t) {
        p[t] = (f32x16){0.f, 0.f, 0.f, 0.f, 0.f, 0.f, 0.f, 0.f, 0.f, 0.f, 0.f, 0.f, 0.f, 0.f, 0.f, 0.f};
#pragma unroll
        for (int d0 = 0; d0 < 4; ++d0) { const bf16x8 kf = *(const LAS bf16x8*)(Ks + (qs + 32 * t + r32) * AT_PITCH + (d0 * 16 + hi * 8) * 2);
            p[t] = __builtin_amdgcn_mfma_f32_32x32x16_bf16(kf, qr[d0], p[t], 0, 0, 0); }
    }
    const float NEGB = -1e30f;
#pragma unroll
    for (int r = 0; r < 16; ++r) { const int kl = crow(r, hi); if (kl <= r32) p[0][r] = NEGB; if (kl > r32) p[4][r] = NEGB; }
    if (q0 < 112) { const int minslot = 112 - q0;
#pragma unroll
        for (int t = 0; t < 5; ++t)
#pragma unroll
            for (int r = 0; r < 16; ++r) if (qs + 32 * t + crow(r, hi) < minslot) p[t][r] = NEGB; }
    float m = p[0][0];
#pragma unroll
    for (int t = 0; t < 5; ++t)
#pragma unroll
        for (int r = 0; r < 16; ++r) m = fmaxf(m, p[t][r]);
    m = fmaxf(m, __shfl_xor(m, 32));
    const float sk = sinks[h] * LOG2E; m = fmaxf(m, sk);
    float l = 0.f;
#pragma unroll
    for (int t = 0; t < 5; ++t)
#pragma unroll
        for (int r = 0; r < 16; ++r) { p[t][r] = fexp2(p[t][r] - m); l += p[t][r]; }
    l += __shfl_xor(l, 32); l += fexp2(sk - m);
    if (hi == 0) wsf[r32] = l;
    f32x16 o[2];
    o[0] = (f32x16){0.f, 0.f, 0.f, 0.f, 0.f, 0.f, 0.f, 0.f, 0.f, 0.f, 0.f, 0.f, 0.f, 0.f, 0.f, 0.f}; o[1] = o[0];
    const int vlane = (4 * hi + ((lane & 15) >> 2)) * AT_PITCH + (((lane >> 4) & 1) * 16 + (lane & 3) * 4) * 2;
#pragma unroll
    for (int t = 0; t < 5; ++t)
#pragma unroll
        for (int s2 = 0; s2 < 2; ++s2) {
            v4u pw; pw.x = pk2(p[t][8 * s2 + 0], p[t][8 * s2 + 1]); pw.y = pk2(p[t][8 * s2 + 2], p[t][8 * s2 + 3]); pw.z = pk2(p[t][8 * s2 + 4], p[t][8 * s2 + 5]); pw.w = pk2(p[t][8 * s2 + 6], p[t][8 * s2 + 7]);
            const bf16x8 pa = __builtin_bit_cast(bf16x8, pw);
            const int kb = qs + 32 * t + 16 * s2;
#pragma unroll
            for (int dt = 0; dt < 2; ++dt) {
                LAS unsigned char* vp = Vs + kb * AT_PITCH + dt * 64 + vlane;
                const s16x4 lo = __builtin_amdgcn_ds_read_tr16_b64_v4i16((LAS s16x4*)vp);
                const s16x4 hh = __builtin_amdgcn_ds_read_tr16_b64_v4i16((LAS s16x4*)(vp + 8 * AT_PITCH));
                const bf16x8 vf = (bf16x8){lo[0], lo[1], lo[2], lo[3], hh[0], hh[1], hh[2], hh[3]};
                o[dt] = __builtin_amdgcn_mfma_f32_32x32x16_bf16(pa, vf, o[dt], 0, 0, 0);
            }
        }
    LDS_WAIT();
    float rl[16];
#pragma unroll
    for (int r = 0; r < 16; ++r) rl[r] = 1.f / wsf[crow(r, hi)];
#pragma unroll
    for (int r = 0; r < 16; ++r) { const int orow = crow(r, hi);
#pragma unroll
        for (int dt = 0; dt < 2; ++dt) stg[orow * 64 + dt * 32 + r32] = (bf16)f2bf(o[dt][r] * rl[r]); }
    LDS_WAIT();
    bf16* Ow = MIX + (size_t)(b * SEQ + q0 + qs) * D + h * 64;
#pragma unroll
    for (int i = 0; i < 4; ++i) { const int row = i * 8 + (lane >> 3), ch = lane & 7; const v4u v = *(const LAS v4u*)(stg + row * 64 + ch * 8); *(GAS v4u*)(Ow + (size_t)row * D + ch * 8) = v; }
    __syncthreads();
}

constexpr int LR_XS = 0, LR_XPITCH = 1040, LR_XC = 69888, LR_XCW = 4608;
struct LruW { bf16x8 Wa[4][2], Wx[4][2]; float ba[2], bx[2], sp8[2], cw[2][4], cb[2]; };
__device__ __forceinline__ void lru_load_consts(LruW& C, const Args& A, int wid, int lane) {
    const int r32 = lane & 31, hi = lane >> 5;
    const float* wa = A.in[6] + wid * 4096; const float* wx = A.in[8] + wid * 4096;
#pragma unroll
    for (int ks = 0; ks < 4; ++ks)
#pragma unroll
        for (int dt = 0; dt < 2; ++dt) {
            const int c0 = 16 * ks + 8 * hi, d = 32 * dt + r32; v4u a, x;
            a.x = pk2(wa[(c0 + 0) * 64 + d], wa[(c0 + 1) * 64 + d]); a.y = pk2(wa[(c0 + 2) * 64 + d], wa[(c0 + 3) * 64 + d]); a.z = pk2(wa[(c0 + 4) * 64 + d], wa[(c0 + 5) * 64 + d]); a.w = pk2(wa[(c0 + 6) * 64 + d], wa[(c0 + 7) * 64 + d]);
            x.x = pk2(wx[(c0 + 0) * 64 + d], wx[(c0 + 1) * 64 + d]); x.y = pk2(wx[(c0 + 2) * 64 + d], wx[(c0 + 3) * 64 + d]); x.z = pk2(wx[(c0 + 4) * 64 + d], wx[(c0 + 5) * 64 + d]); x.w = pk2(wx[(c0 + 6) * 64 + d], wx[(c0 + 7) * 64 + d]);
            C.Wa[ks][dt] = __builtin_bit_cast(bf16x8, a); C.Wx[ks][dt] = __builtin_bit_cast(bf16x8, x);
        }
#pragma unroll
    for (int dt = 0; dt < 2; ++dt) { const int ch = 64 * wid + 32 * dt + r32;
        C.ba[dt] = A.in[7][ch]; C.bx[dt] = A.in[9][ch]; C.sp8[dt] = 8.0f * log1pf(expf(-A.in[10][ch])); C.cb[dt] = A.in[5][ch];
#pragma unroll
        for (int j = 0; j < 4; ++j) C.cw[dt][j] = A.in[4][j * LRUW + ch]; }
}
template <bool META>
__device__ __forceinline__ void lru_unit(int b, int k, const LruW& C, const bf16* Z, unsigned* STASH, float* SUMP, float* SUMH, float* METAH, LAS unsigned char* lds, int tid) {
    const int lane = tid & 63, wid = __builtin_amdgcn_readfirstlane(tid >> 6), r32 = lane & 31, hi = lane >> 5;
    const int base = META ? MTOK : b * SEQ + 64 * k;
    LAS unsigned char* XS = lds + LR_XS; LAS unsigned char* XC = lds + LR_XC + wid * LR_XCW;
    for (int idx = tid; idx < 67 * 64; idx += 512) {
        const int r = idx >> 6, c = idx & 63, tok = r - 3; v4u v = (v4u){0u, 0u, 0u, 0u};
        if (META) { if (tok >= 0) v = *(const GAS v4u*)(Z + (size_t)(MTOK + tok) * INW + ZXR + c * 8); }
        else { const size_t row = (tok >= 0 || k > 0) ? (size_t)(base + tok) : (size_t)(MTOK + NMETA + tok); v = *(const GAS v4u*)(Z + row * INW + ZXR + c * 8); }
        *(LAS v4u*)(XS + r * LR_XPITCH + c * 16) = v;
    }
    __syncthreads();
    float hcar[2] = {0.f, 0.f}, ccar[2] = {1.f, 1.f};
#pragma unroll
    for (int mt = 0; mt < (META ? 1 : 2); ++mt) {
        float xc[2][16];
#pragma unroll
        for (int dt = 0; dt < 2; ++dt) {
            const int chl = 32 * dt + r32, ch = 64 * wid + chl;
#pragma unroll
            for (int rg = 0; rg < 4; ++rg) {
                const int tb = 32 * mt + 8 * rg + 4 * hi; float xv[7];
#pragma unroll
                for (int i = 0; i < 7; ++i) xv[i] = bf2f(*(const LAS unsigned short*)(XS + (tb + i) * LR_XPITCH + ch * 2));
#pragma unroll
                for (int kk = 0; kk < 4; ++kk) xc[dt][4 * rg + kk] = C.cb[dt] + C.cw[dt][0] * xv[kk] + C.cw[dt][1] * xv[kk + 1] + C.cw[dt][2] * xv[kk + 2] + C.cw[dt][3] * xv[kk + 3];
            }
#pragma unroll
            for (int r = 0; r < 16; ++r) *(LAS unsigned short*)(XC + crow(r, hi) * 144 + chl * 2) = (unsigned short)f2bf(xc[dt][r]);
        }
        LDS_WAIT();
        bf16x8 xa[4];
#pragma unroll
        for (int ks = 0; ks < 4; ++ks) xa[ks] = *(const LAS bf16x8*)(XC + r32 * 144 + (ks * 16 + hi * 8) * 2);
        LDS_WAIT();
#pragma unroll
        for (int dt = 0; dt < 2; ++dt) {
            const int ch = 64 * wid + 32 * dt + r32;
            f32x16 ar = (f32x16){0.f, 0.f, 0.f, 0.f, 0.f, 0.f, 0.f, 0.f, 0.f, 0.f, 0.f, 0.f, 0.f, 0.f, 0.f, 0.f}, ai = ar;
#pragma unroll
            for (int ks = 0; ks < 4; ++ks) { ar = __builtin_amdgcn_mfma_f32_32x32x16_bf16(xa[ks], C.Wa[ks][dt], ar, 0, 0, 0); ai = __builtin_amdgcn_mfma_f32_32x32x16_bf16(xa[ks], C.Wx[ks][dt], ai, 0, 0, 0); }
            float av[16], uv[16];
#pragma unroll
            for (int r = 0; r < 16; ++r) {
                const float rr = frcp(1.f + fexp2(-(ar[r] + C.ba[dt]) * LOG2E)), ii = frcp(1.f + fexp2(-(ai[r] + C.bx[dt]) * LOG2E));
                const float la = -C.sp8[dt] * rr, a = fexp2(la * LOG2E), x2 = 2.f * la;
                const float om = (x2 > -0.25f) ? -x2 * (1.f + x2 * (0.5f + x2 * (0.16666667f + x2 * (0.041666668f + x2 * 0.0083333338f)))) : 1.f - a * a;
                av[r] = a; uv[r] = __builtin_sqrtf(om) * ii * xc[dt][r];
            }
#pragma unroll
            for (int rg = 0; rg < (META ? 2 : 4); ++rg) {
                const float c0 = av[4 * rg], c1 = av[4 * rg + 1] * c0, c2 = av[4 * rg + 2] * c1, c3 = av[4 * rg + 3] * c2;
                const float q0 = uv[4 * rg], q1 = av[4 * rg + 1] * q0 + uv[4 * rg + 1], q2 = av[4 * rg + 2] * q1 + uv[4 * rg + 2], q3 = av[4 * rg + 3] * q2 + uv[4 * rg + 3];
#pragma unroll
                for (int h0 = 0; h0 < 2; ++h0) {
                    const bool mine = (hi == h0);
                    const float H0 = q0 + c0 * hcar[dt], H1 = q1 + c1 * hcar[dt], H2 = q2 + c2 * hcar[dt], H3 = q3 + c3 * hcar[dt];
                    const float A0 = c0 * ccar[dt], A1 = c1 * ccar[dt], A2 = c2 * ccar[dt], A3 = c3 * ccar[dt];
                    if (mine) { uv[4 * rg] = H0; uv[4 * rg + 1] = H1; uv[4 * rg + 2] = H2; uv[4 * rg + 3] = H3; av[4 * rg] = A0; av[4 * rg + 1] = A1; av[4 * rg + 2] = A2; av[4 * rg + 3] = A3; }
                    const float ph = __shfl_xor(H3, 32), pc = __shfl_xor(A3, 32);
                    hcar[dt] = mine ? H3 : ph; ccar[dt] = mine ? A3 : pc;
                }
            }
            if (!META) {
#pragma unroll
                for (int r = 0; r < 16; ++r) STASH[(size_t)(base + 32 * mt + crow(r, hi)) * LRUW + ch] = f2bf(uv[r]) | (f2bf(av[r]) << 16);
            }
        }
    }
    if (hi == 0) {
#pragma unroll
        for (int dt = 0; dt < 2; ++dt) { const int ch = 64 * wid + 32 * dt + r32;
            if (META) METAH[ch] = hcar[dt];
            else { SUMP[(size_t)(b * NCHUNK + k) * LRUW + ch] = ccar[dt]; SUMH[(size_t)(b * NCHUNK + k) * LRUW + ch] = hcar[dt]; } }
    }
    __syncthreads();
}

__device__ __forceinline__ void lru_fix_phase(const bf16* Z, const unsigned* STASH, const float* SUMP, const float* SUMH, const float* METAH, bf16* MIX, int tid, int G) {
    const int ch = tid;
    for (int pair = blockIdx.x; pair < NB * NCHUNK / 2; pair += G) {
        const int b = pair / (NCHUNK / 2), k0 = (pair % (NCHUNK / 2)) * 2;
        float carry = METAH[ch];
        for (int kk = 0; kk < k0; ++kk) carry = SUMP[(size_t)(b * NCHUNK + kk) * LRUW + ch] * carry + SUMH[(size_t)(b * NCHUNK + kk) * LRUW + ch];
        for (int k = k0; k < k0 + 2; ++k) {
            const size_t r0 = (size_t)b * SEQ + 64 * k;
#pragma unroll 8
            for (int r = 0; r < 64; ++r) {
                const unsigned w = STASH[(r0 + r) * LRUW + ch];
                const float hl = bf2f(w & 0xffffu), ac = bf2f(w >> 16), hh = hl + ac * carry;
                const float y = bf2f(Z[(r0 + r) * INW + ZYR + ch]);
                const float zz = 0.7978845608028654f * (y + 0.044715f * y * y * y);
                const float gl = y * frcp(1.f + fexp2(-2.f * LOG2E * zz));
                MIX[(r0 + r) * D + LRUW + ch] = (bf16)f2bf(gl * hh);
            }
            carry = SUMP[(size_t)(b * NCHUNK + k) * LRUW + ch] * carry + SUMH[(size_t)(b * NCHUNK + k) * LRUW + ch];
        }
    }
}

__device__ __forceinline__ f32x4 ld_bf16x4(const bf16* p) { const v2u w = *(const GAS v2u*)p; return (f32x4){bf2f(w.x & 0xffffu), bf2f(w.x >> 16), bf2f(w.y & 0xffffu), bf2f(w.y >> 16)}; }
__device__ __forceinline__ void p5_rows(const Args& A, int wave, int lane, int G) {
    const int gw = blockIdx.x * NWAVES + wave, NGW = G * NWAVES;
    const bf16* Y = (const bf16*)(A.ws + WS_Y); bf16* XN = (bf16*)(A.ws + WS_XN);
    f32x4 g1[4], g2[4];
#pragma unroll
    for (int j = 0; j < 4; ++j) { g1[j] = *((const GAS f32x4*)A.in[13] + lane + 64 * j); g2[j] = *((const GAS f32x4*)A.in[14] + lane + 64 * j); }
    for (int m = gw; m < MTOK; m += NGW) {
        f32x4 y[4], x[4]; float s = 0.f;
#pragma unroll
        for (int j = 0; j < 4; ++j) { y[j] = ld_bf16x4(Y + (size_t)m * D + 4 * lane + 256 * j); x[j] = *((const GAS f32x4*)(A.in[0] + (size_t)m * D) + lane + 64 * j);
            s += (y[j].x * y[j].x + y[j].y * y[j].y) + (y[j].z * y[j].z + y[j].w * y[j].w); }
        const float rs = 1.f / sqrtf(wave_sum(s) * (1.f / D) + EPS); float s2 = 0.f;
#pragma unroll
        for (int j = 0; j < 4; ++j) { x[j] = x[j] + y[j] * rs * g1[j]; *((GAS f32x4*)(A.out + (size_t)m * D) + lane + 64 * j) = x[j];
            s2 += (x[j].x * x[j].x + x[j].y * x[j].y) + (x[j].z * x[j].z + x[j].w * x[j].w); }
        const float rs2 = 1.f / sqrtf(wave_sum(s2) * (1.f / D) + EPS);
        GAS unsigned long long* o8 = (GAS unsigned long long*)(XN + (size_t)m * D) + lane;
#pragma unroll
        for (int j = 0; j < 4; ++j) { const f32x4 w = x[j] * rs2 * g2[j]; o8[64 * j] = (unsigned long long)pk2(w.x, w.y) | ((unsigned long long)pk2(w.z, w.w) << 32); }
    }
}
__device__ __forceinline__ void p8_rows(const Args& A, int wave, int lane, int G) {
    const int gw = blockIdx.x * NWAVES + wave, NGW = G * NWAVES;
    const bf16* Fb = (const bf16*)(A.ws + WS_F);
    f32x4 g3[4];
#pragma unroll
    for (int j = 0; j < 4; ++j) g3[j] = *((const GAS f32x4*)A.in[17] + lane + 64 * j);
    for (int m = gw; m < MTOK; m += NGW) {
        f32x4 y[4], x[4]; float s = 0.f;
#pragma unroll
        for (int j = 0; j < 4; ++j) { y[j] = ld_bf16x4(Fb + (size_t)m * D + 4 * lane + 256 * j); x[j] = *((const GAS f32x4*)(A.out + (size_t)m * D) + lane + 64 * j);
            s += (y[j].x * y[j].x + y[j].y * y[j].y) + (y[j].z * y[j].z + y[j].w * y[j].w); }
        const float rs = 1.f / sqrtf(wave_sum(s) * (1.f / D) + EPS);
#pragma unroll
        for (int j = 0; j < 4; ++j) *((GAS f32x4*)(A.out + (size_t)m * D) + lane + 64 * j) = x[j] + y[j] * rs * g3[j];
    }
}

__global__ void __launch_bounds__(NWAVES * 64, 2) hymba_fwd(Args args) {
    extern __shared__ __attribute__((aligned(16))) unsigned char lds_raw[];
    cg::grid_group grid = cg::this_grid();
    LAS unsigned char* lds = (LAS unsigned char*)lds_raw;
    const int tid = threadIdx.x, lane = tid & 63, wave = __builtin_amdgcn_readfirstlane(tid >> 6), G = gridDim.x;
    unsigned char* ws = args.ws;
    bf16* XN = (bf16*)(ws + WS_XN); bf16* Zb = (bf16*)(ws + WS_Z); bf16* MIX = (bf16*)(ws + WS_MIX); bf16* Yb = (bf16*)(ws + WS_Y);
    bf16* HB = (bf16*)(ws + WS_HB); bf16* Fb = (bf16*)(ws + WS_F);
    unsigned* STASH = (unsigned*)(ws + WS_STASH); float* SUMP = (float*)(ws + WS_SUMP); float* SUMH = (float*)(ws + WS_SUMH); float* METAH = (float*)(ws + WS_METAH);

    p0_prologue(args, lds, wave, lane, G);
    grid.sync();
    { pg8::Gemm g{XN, (const bf16*)(ws + WS_WIN), MPAD, INW, D}; pg8::StaticOrder S; S.init(MPAD, INW, G, (int)blockIdx.x);
      pg8::EpiBf16<0> E{Zb, INW, nullptr, 512, (size_t)512, QSCALE};
      pg8::gemm_phase<pg8::EpiBf16<0>, pg8::StaticOrder, true, true>(lds, g, S, E); }
    grid.sync();
    {
        LruW C; lru_load_consts(C, args, wave, lane);
        for (int u = blockIdx.x; u < NB * NCHUNK + 1; u += G) {
            if (u == NB * NCHUNK) lru_unit<true>(0, 0, C, Zb, STASH, SUMP, SUMH, METAH, lds, tid);
            else lru_unit<false>(u / NCHUNK, u % NCHUNK, C, Zb, STASH, SUMP, SUMH, METAH, lds, tid);
        }
    }
    for (int u = blockIdx.x; u < NB * 2 * (SEQ / 64); u += G) {
        const int qt = u % (SEQ / 64), bk = u / (SEQ / 64);
        attn_unit(bk >> 1, bk & 1, qt, Zb, args.in[11], MIX, lds, tid);
    }
    grid.sync();
    lru_fix_phase(Zb, STASH, SUMP, SUMH, METAH, MIX, tid, G);
    grid.sync();
    { pg8::Gemm g{MIX, (const bf16*)(ws + WS_WOUT), MTOK, D, D}; pg8::StaticOrder S; S.init(MTOK, D, G, (int)blockIdx.x);
      pg8::EpiBf16<0> E{Yb, D, nullptr, 0, (size_t)0, 1.f};
      pg8::gemm_phase<pg8::EpiBf16<0>, pg8::StaticOrder, true, true>(lds, g, S, E); }
    grid.sync();
    p5_rows(args, wave, lane, G);
    grid.sync();
    { pg8::Gemm g{XN, (const bf16*)(ws + WS_W1), MTOK, FF, D}; pg8::StaticOrder S; S.init(MTOK, FF, G, (int)blockIdx.x);
      pg8::EpiBf16<2> E{HB, FF, nullptr, 0, (size_t)0, 1.f};
      pg8::gemm_phase<pg8::EpiBf16<2>, pg8::StaticOrder, true, true>(lds, g, S, E); }
    grid.sync();
    { pg8::Gemm g{HB, (const bf16*)(ws + WS_W2), MTOK, D, FF}; pg8::StaticOrder S; S.init(MTOK, D, G, (int)blockIdx.x);
      pg8::EpiBf16<0> E{Fb, D, nullptr, 0, (size_t)0, 1.f};
      pg8::gemm_phase<pg8::EpiBf16<0>, pg8::StaticOrder, true, true>(lds, g, S, E); }
    grid.sync();
    p8_rows(args, wave, lane, G);
}

extern "C" void kernel_launch(void* const* d_in, const int* in_sizes, int n_in, void* d_out, int out_size, void* d_ws, size_t ws_size, hipStream_t stream) {
    static int grid = 0;
    if (grid == 0) {
        if (n_in != 18 || in_sizes[0] != MTOK * D || out_size != MTOK * D || ws_size < WS_END) { fprintf(stderr, "kernel_launch: unexpected shapes (n_in %d, in0 %d, out %d, ws %zu); nothing launched\n", n_in, n_in > 0 ? in_sizes[0] : -1, out_size, ws_size); grid = -1; return; }
        int dev = 0, cus = 0, per_cu = 0;
        if (hipGetDevice(&dev) != hipSuccess || hipDeviceGetAttribute(&cus, hipDeviceAttributeMultiprocessorCount, dev) != hipSuccess) { grid = -1; return; }
        if (hipFuncSetAttribute((const void*)hymba_fwd, hipFuncAttributeMaxDynamicSharedMemorySize, LDS_BYTES) != hipSuccess) { fprintf(stderr, "kernel_launch: hipFuncSetAttribute failed\n"); grid = -1; return; }
        if (hipOccupancyMaxActiveBlocksPerMultiprocessor(&per_cu, (const void*)hymba_fwd, NWAVES * 64, LDS_BYTES) != hipSuccess || per_cu < 1) { fprintf(stderr, "kernel_launch: occupancy query gave %d\n", per_cu); per_cu = 1; }
        (void)hipGetLastError();
        grid = cus * per_cu;
    }
    if (grid < 0) return;
    Args a{};
    for (int i = 0; i < 18; ++i) a.in[i] = (const float*)d_in[i];
    a.out = (float*)d_out; a.ws = (unsigned char*)d_ws;
    void* kargs[] = {&a};
    const hipError_t le = hipLaunchCooperativeKernel((const void*)hymba_fwd, dim3(grid), dim3(NWAVES * 64), kargs, LDS_BYTES, stream);
    if (le != hipSuccess) fprintf(stderr, "kernel_launch: cooperative launch failed: %s (grid %d)\n", hipGetErrorName(le), grid);
}
```
